# Optimizing an MI355X kernel written in HIP

```python
import math
import jax, jax.numpy as jnp
from jax import lax
import numpy as np

D_MODEL = 1024
BATCH = 8
SEQ = 2048
DEPTH = 2

N_A = DEPTH // 2
N_B = DEPTH - N_A
HG_DK = 128
HG_HEADS = D_MODEL // HG_DK
HG_DV = D_MODEL // HG_HEADS
HG_WIDTH = HG_HEADS * HG_DK
HG_VWIDTH = HG_HEADS * HG_DV
HG_CHUNK = 64
ATT_HD = 64
ATT_QH = D_MODEL // ATT_HD
ATT_KVH = 4
ATT_G = ATT_QH // ATT_KVH
WINDOW = 128
FFN_HIDDEN = -(-8 * D_MODEL // (3 * 256)) * 256
PLE_DIM = 256
DEEPNORM_ALPHA = (2.0 * DEPTH) ** 0.25
DEEPNORM_BETA = (8.0 * DEPTH) ** -0.25
LN_EPS = 1e-5
RMS_EPS = 1e-6

kernel_name = 'yoco_hgrn2_swa_sink_alibi_deepnorm'


def layer_norm(x, g, b):
    xf = x.astype(jnp.float32)
    mu = jnp.mean(xf, axis=-1, keepdims=True)
    var = jnp.mean(jnp.square(xf - mu), axis=-1, keepdims=True)
    return ((xf - mu) * lax.rsqrt(var + LN_EPS) * g.astype(jnp.float32) + b.astype(jnp.float32)).astype(x.dtype)


def rms_norm(x, g):
    xf = x.astype(jnp.float32)
    return xf * lax.rsqrt(jnp.mean(jnp.square(xf), axis=-1, keepdims=True) + RMS_EPS) * g.astype(jnp.float32)


def hgrn2_mixer(x, w_in, lb, norm_gain, w_out):
    B, S, _ = x.shape
    f32 = jnp.float32
    proj = x @ w_in
    q = proj[..., :HG_WIDTH]
    f = proj[..., HG_WIDTH:2 * HG_WIDTH].astype(f32)
    v = proj[..., 2 * HG_WIDTH:2 * HG_WIDTH + HG_VWIDTH].astype(f32)
    g = proj[..., 2 * HG_WIDTH + HG_VWIDTH:]
    lb = lb.astype(f32)
    forget = lb + (1.0 - lb) * jax.nn.sigmoid(f)
    log_f = jnp.log(forget)
    k = (1.0 - lb) * jax.nn.sigmoid(-f)
    q = jax.nn.silu(q.astype(f32)) * (HG_DK ** -0.5)
    nc = S // HG_CHUNK

    def to_chunks(t, d):
        return t.reshape(B, nc, HG_CHUNK, HG_HEADS, d).transpose(1, 0, 3, 2, 4)

    causal = jnp.tril(jnp.ones((HG_CHUNK, HG_CHUNK), dtype=bool))[:, :, None]

    def step(state, inp):
        qc, kc, gc, vc = inp
        b = jnp.cumsum(gc, axis=2)
        diff = b[:, :, :, None, :] - b[:, :, None, :, :]
        decay = jnp.exp(jnp.where(causal, diff, -jnp.inf))
        scores = jnp.einsum('bhtc,bhsc,bhtsc->bhts', qc, kc, decay)
        o = jnp.einsum('bhts,bhsv->bhtv', scores, vc) + jnp.einsum('bhtc,bhcv->bhtv', qc * jnp.exp(b), state)
        b_last = b[:, :, -1:, :]
        state = jnp.exp(b_last[:, :, 0, :, None]) * state + jnp.einsum('bhsc,bhsv->bhcv', kc * jnp.exp(b_last - b), vc)
        return state, o

    s0 = jnp.zeros((B, HG_HEADS, HG_DK, HG_DV), f32)
    _, o = lax.scan(step, s0, (to_chunks(q, HG_DK), to_chunks(k, HG_DK), to_chunks(log_f, HG_DK), to_chunks(v, HG_DV)))
    o = o.transpose(1, 0, 3, 2, 4).reshape(B, S, HG_HEADS, HG_DV)
    o = rms_norm(o, norm_gain) * jax.nn.silu(g.astype(f32)).reshape(B, S, HG_HEADS, HG_DV)
    return o.reshape(B, S, HG_VWIDTH).astype(x.dtype) @ w_out


def shared_kv(h, kv_w, kv_b):
    B, S, _ = h.shape
    kv = h @ kv_w + kv_b
    kdim = ATT_KVH * ATT_HD
    return kv[..., :kdim].reshape(B, S, ATT_KVH, ATT_HD), kv[..., kdim:].reshape(B, S, ATT_KVH, ATT_HD)


def band_blocks(t):
    B, S = t.shape[:2]
    tp = jnp.pad(t, ((0, 0), (WINDOW, 0), (0, 0), (0, 0)))
    tr = tp.reshape(B, S // WINDOW + 1, WINDOW, ATT_KVH, ATT_HD)
    return jnp.concatenate([tr[:, :-1], tr[:, 1:]], axis=2)


def alibi_slopes(n_heads):
    return jnp.exp2(-8.0 * jnp.arange(1, n_heads + 1, dtype=jnp.float32) / n_heads)


def swa_sink_mixer(x, k_blocks, v_blocks, w_q, b_q, sinks, w_out, b_out):
    B, S, _ = x.shape
    nb = S // WINDOW
    f32 = jnp.float32
    q = (x @ w_q + b_q).reshape(B, nb, WINDOW, ATT_KVH, ATT_G, ATT_HD)
    s = jnp.einsum('bnqkgd,bnskd->bnkgqs', q, k_blocks).astype(f32) * (ATT_HD ** -0.5)
    qi = jnp.arange(WINDOW)[:, None]
    si = jnp.arange(2 * WINDOW)[None, :]
    dist = qi - si + WINDOW
    blk = jnp.arange(nb)[:, None, None]
    valid = (dist >= 0) & (dist < WINDOW) & (blk * WINDOW - WINDOW + si >= 0)
    slopes = alibi_slopes(ATT_QH).reshape(ATT_KVH, ATT_G)
    s = s - slopes[:, :, None, None] * dist.astype(f32)
    s = jnp.where(valid[None, :, None, None], s, -jnp.inf)
    sink = jnp.broadcast_to(sinks.astype(f32).reshape(ATT_KVH, ATT_G)[None, None, :, :, None, None], s.shape[:-1] + (1,))
    probs = jax.nn.softmax(jnp.concatenate([s, sink], axis=-1), axis=-1)[..., :-1]
    o = jnp.einsum('bnkgqs,bnskd->bnqkgd', probs.astype(v_blocks.dtype), v_blocks).reshape(B, S, ATT_QH * ATT_HD)
    return o @ w_out + b_out


def swiglu(x, w_gate_up, w_down):
    gu = x @ w_gate_up
    return (jax.nn.silu(gu[..., :FFN_HIDDEN]) * gu[..., FFN_HIDDEN:]) @ w_down


def per_layer_embedding(x, p_i, w_up, w_gate, b_gate):
    return jax.nn.sigmoid(x @ w_gate + b_gate) * (p_i @ w_up)


def setup_inputs(seed: int = 0) -> dict:
    key = jax.random.key(seed)
    ks = jax.random.split(key, 24)
    D = D_MODEL
    nrm = lambda k, shape, scale: jax.random.normal(k, shape, jnp.float32) * scale
    kvd = ATT_KVH * ATT_HD
    qd = ATT_QH * ATT_HD
    return {
        'x': nrm(ks[0], (BATCH, SEQ, D), 1.0),
        'p': nrm(ks[1], (DEPTH, BATCH, SEQ, PLE_DIM), 1.0),
        'a_w_in': jnp.concatenate([
            nrm(ks[2], (N_A, D, 2 * HG_WIDTH), D ** -0.5),
            nrm(ks[3], (N_A, D, HG_VWIDTH), D ** -0.5 * DEEPNORM_BETA),
            nrm(ks[4], (N_A, D, HG_VWIDTH), D ** -0.5)], axis=-1),
        'a_lower_bound': nrm(ks[5], (N_A + 1, HG_WIDTH), 0.5),
        'a_norm_gain': 1.0 + nrm(ks[6], (N_A, HG_DV), 0.05),
        'a_w_out': nrm(ks[7], (N_A, HG_VWIDTH, D), HG_VWIDTH ** -0.5 * DEEPNORM_BETA),
        'kv_w': jnp.concatenate([
            nrm(ks[8], (D, kvd), D ** -0.5),
            nrm(ks[9], (D, kvd), D ** -0.5 * DEEPNORM_BETA)], axis=-1),
        'kv_b': nrm(ks[10], (2 * kvd,), 0.02),
        'b_w_q': nrm(ks[11], (N_B, D, qd), D ** -0.5),
        'b_b_q': nrm(ks[12], (N_B, qd), 0.02),
        'b_sinks': nrm(ks[13], (N_B, ATT_QH), 1.0),
        'b_w_out': nrm(ks[14], (N_B, qd, D), qd ** -0.5 * DEEPNORM_BETA),
        'b_b_out': nrm(ks[15], (N_B, D), 0.02),
        'ffn_w_gate_up': nrm(ks[16], (DEPTH, D, 2 * FFN_HIDDEN), D ** -0.5),
        'ffn_w_down': nrm(ks[17], (DEPTH, FFN_HIDDEN, D), FFN_HIDDEN ** -0.5 * DEEPNORM_BETA),
        'ple_w_up': nrm(ks[18], (DEPTH, PLE_DIM, D), PLE_DIM ** -0.5 * DEEPNORM_BETA),
        'ple_w_gate': nrm(ks[19], (DEPTH, D, D), D ** -0.5),
        'ple_b_gate': nrm(ks[20], (DEPTH, D), 0.02),
        'ln_gain': 1.0 + nrm(ks[21], (DEPTH, 3, D), 0.05),
        'ln_bias': nrm(ks[22], (DEPTH, 3, D), 0.02),
    }


def reference(x, p, a_w_in, a_lower_bound, a_norm_gain, a_w_out, kv_w, kv_b, b_w_q, b_b_q, b_sinks, b_w_out, b_b_out,
              ffn_w_gate_up, ffn_w_down, ple_w_up, ple_w_gate, ple_b_gate, ln_gain, ln_bias):
    lower_bounds = jnp.cumsum(jax.nn.softmax(a_lower_bound.astype(jnp.float32), axis=0), axis=0)
    k_blocks = None
    v_blocks = None
    for i in range(DEPTH):
        if i < N_A:
            h = hgrn2_mixer(x, a_w_in[i], lower_bounds[i], a_norm_gain[i], a_w_out[i])
        else:
            if i == N_A:
                k_sh, v_sh = shared_kv(x, kv_w, kv_b)
                k_blocks = band_blocks(k_sh)
                v_blocks = band_blocks(v_sh)
            j = i - N_A
            h = swa_sink_mixer(x, k_blocks, v_blocks, b_w_q[j], b_b_q[j], b_sinks[j], b_w_out[j], b_b_out[j])
        x = layer_norm(DEEPNORM_ALPHA * x + h, ln_gain[i, 0], ln_bias[i, 0])
        x = layer_norm(DEEPNORM_ALPHA * x + swiglu(x, ffn_w_gate_up[i], ffn_w_down[i]), ln_gain[i, 1], ln_bias[i, 1])
        x = layer_norm(DEEPNORM_ALPHA * x + per_layer_embedding(x, p[i], ple_w_up[i], ple_w_gate[i], ple_b_gate[i]),
                       ln_gain[i, 2], ln_bias[i, 2])
    return x
```

```cpp
#include <hip/hip_runtime.h>
#include <cstdio>
#include <cstdint>

namespace nv {
constexpr int D = 1024, B = 8, S = 2048, FF = 2816, PLE = 256;
constexpr float ALPHA = 1.4142135623730951f;
constexpr float LN_EPS = 1e-5f, RMS_EPS = 1e-6f;

__global__ void __launch_bounds__(256) k_gemm(const float* __restrict__ A, int lda, const float* __restrict__ W, int ldw,
                                              const float* __restrict__ bias, float* __restrict__ C, int ldc, int K) {
    __shared__ float As[16][65];
    __shared__ float Ws[16][64];
    const int tx = threadIdx.x & 15, ty = threadIdx.x >> 4;
    const int m0 = blockIdx.y * 64, n0 = blockIdx.x * 64;
    float acc[4][4];
#pragma unroll
    for (int i = 0; i < 4; ++i)
#pragma unroll
        for (int j = 0; j < 4; ++j) acc[i][j] = 0.f;
    for (int k0 = 0; k0 < K; k0 += 16) {
#pragma unroll
        for (int i = 0; i < 4; ++i) {
            const int e = threadIdx.x + i * 256, r = e >> 4, c = e & 15;
            As[c][r] = A[(size_t)(m0 + r) * lda + k0 + c];
        }
#pragma unroll
        for (int i = 0; i < 4; ++i) {
            const int e = threadIdx.x + i * 256, r = e >> 6, c = e & 63;
            Ws[r][c] = W[(size_t)(k0 + r) * ldw + n0 + c];
        }
        __syncthreads();
#pragma unroll
        for (int kk = 0; kk < 16; ++kk) {
            float a[4], w[4];
#pragma unroll
            for (int i = 0; i < 4; ++i) a[i] = As[kk][ty * 4 + i];
#pragma unroll
            for (int j = 0; j < 4; ++j) w[j] = Ws[kk][tx * 4 + j];
#pragma unroll
            for (int i = 0; i < 4; ++i)
#pragma unroll
                for (int j = 0; j < 4; ++j) acc[i][j] = fmaf(a[i], w[j], acc[i][j]);
        }
        __syncthreads();
    }
#pragma unroll
    for (int i = 0; i < 4; ++i)
#pragma unroll
        for (int j = 0; j < 4; ++j) {
            const int r = m0 + ty * 4 + i, c = n0 + tx * 4 + j;
            C[(size_t)r * ldc + c] = acc[i][j] + (bias ? bias[c] : 0.f);
        }
}

__device__ __forceinline__ float sigmoidf_(float x) { return 1.f / (1.f + expf(-x)); }
__device__ __forceinline__ float siluf_(float x) { return x * sigmoidf_(x); }

__global__ void k_lb(const float* __restrict__ alb, float* __restrict__ lb) {
    const int c = blockIdx.x * blockDim.x + threadIdx.x;
    if (c < 1024) { const float a0 = alb[c], a1 = alb[1024 + c]; const float m = fmaxf(a0, a1); const float e0 = expf(a0 - m), e1 = expf(a1 - m); lb[c] = e0 / (e0 + e1); }
}

__global__ void __launch_bounds__(128) k_hgrn(const float* __restrict__ proj, const float* __restrict__ lb, float* __restrict__ o) {
    const int h = blockIdx.x, j = threadIdx.x;
    __shared__ float sq[128], sf[128], sk[128];
    float St[128];
#pragma unroll
    for (int c = 0; c < 128; ++c) St[c] = 0.f;
    for (int t = 0; t < S; ++t) {
        const float* row = proj + (size_t)t * 4096;
        {
            const float qv = row[h * 128 + j], fv = row[1024 + h * 128 + j];
            const float l = lb[h * 128 + j];
            const float sg = sigmoidf_(fv);
            sq[j] = siluf_(qv) * 0.08838834764831845f;
            sf[j] = l + (1.f - l) * sg;
            sk[j] = (1.f - l) * sigmoidf_(-fv);
        }
        __syncthreads();
        const float v = row[2048 + h * 128 + j];
        float acc = 0.f;
#pragma unroll
        for (int c = 0; c < 128; ++c) { St[c] = fmaf(sf[c], St[c], sk[c] * v); acc = fmaf(sq[c], St[c], acc); }
        o[(size_t)t * 1024 + h * 128 + j] = acc;
        __syncthreads();
    }
}

__global__ void __launch_bounds__(128) k_gatenorm(const float* __restrict__ o, const float* __restrict__ proj, const float* __restrict__ gain, float* __restrict__ og) {
    const int t = blockIdx.x, h = blockIdx.y, d = threadIdx.x;
    __shared__ float red[2];
    const float v = o[(size_t)t * 1024 + h * 128 + d];
    float s = v * v;
#pragma unroll
    for (int off = 32; off > 0; off >>= 1) s += __shfl_xor(s, off);
    if ((d & 63) == 0) red[d >> 6] = s;
    __syncthreads();
    const float ms = (red[0] + red[1]) * (1.f / 128.f);
    const float g = proj[(size_t)t * 4096 + 3072 + h * 128 + d];
    og[(size_t)t * 1024 + h * 128 + d] = v * rsqrtf(ms + RMS_EPS) * gain[d] * siluf_(g);
}

__global__ void __launch_bounds__(256) k_addln(const float* __restrict__ xin, const float* __restrict__ hh, const float* __restrict__ g, const float* __restrict__ bb, float* __restrict__ xout) {
    const int r = blockIdx.x, tid = threadIdx.x;
    __shared__ float red[4];
    float v[4]; float s = 0.f;
#pragma unroll
    for (int i = 0; i < 4; ++i) { const int c = tid + i * 256; v[i] = ALPHA * xin[(size_t)r * 1024 + c] + hh[(size_t)r * 1024 + c]; s += v[i]; }
#pragma unroll
    for (int off = 32; off > 0; off >>= 1) s += __shfl_xor(s, off);
    if ((tid & 63) == 0) red[tid >> 6] = s;
    __syncthreads();
    const float mean = (red[0] + red[1] + red[2] + red[3]) * (1.f / 1024.f);
    __syncthreads();
    float q = 0.f;
#pragma unroll
    for (int i = 0; i < 4; ++i) { const float dlt = v[i] - mean; q += dlt * dlt; }
#pragma unroll
    for (int off = 32; off > 0; off >>= 1) q += __shfl_xor(q, off);
    if ((tid & 63) == 0) red[tid >> 6] = q;
    __syncthreads();
    const float var = (red[0] + red[1] + red[2] + red[3]) * (1.f / 1024.f);
    const float rstd = rsqrtf(var + LN_EPS);
#pragma unroll
    for (int i = 0; i < 4; ++i) { const int c = tid + i * 256; xout[(size_t)r * 1024 + c] = (v[i] - mean) * rstd * g[c] + bb[c]; }
}

__global__ void k_swiglu(const float* __restrict__ gu, float* __restrict__ hs, int n) {
    const int i = blockIdx.x * blockDim.x + threadIdx.x;
    if (i < n) { const int r = i / FF, c = i % FF; hs[i] = siluf_(gu[(size_t)r * 2 * FF + c]) * gu[(size_t)r * 2 * FF + FF + c]; }
}
__global__ void k_sigmul(const float* __restrict__ gt, const float* __restrict__ up, float* __restrict__ hh, int n) {
    const int i = blockIdx.x * blockDim.x + threadIdx.x;
    if (i < n) hh[i] = sigmoidf_(gt[i]) * up[i];
}

__global__ void __launch_bounds__(64) k_swa(const float* __restrict__ q, const float* __restrict__ kv, const float* __restrict__ sinks, float* __restrict__ o) {
    const int t = blockIdx.x, hq = blockIdx.y, lane = threadIdx.x, kvh = hq >> 2;
    __shared__ float sqv[64];
    __shared__ float pr[128];
    sqv[lane] = q[(size_t)t * 1024 + hq * 64 + lane];
    __syncthreads();
    const float slope = exp2f(-8.0f * (float)(hq + 1) / 16.0f);
    float sc[2];
#pragma unroll
    for (int i = 0; i < 2; ++i) {
        const int dist = lane + 64 * i;
        const int s = t - dist;
        float v = -INFINITY;
        if (s >= 0) {
            const float* kr = kv + (size_t)s * 512 + kvh * 64;
            float a = 0.f;
            for (int d = 0; d < 64; ++d) a = fmaf(sqv[d], kr[d], a);
            v = a * 0.125f - slope * (float)dist;
        }
        sc[i] = v;
    }
    const float sink = sinks[hq];
    float m = fmaxf(fmaxf(sc[0], sc[1]), sink);
#pragma unroll
    for (int off = 32; off > 0; off >>= 1) m = fmaxf(m, __shfl_xor(m, off));
    const float e0 = expf(sc[0] - m), e1 = expf(sc[1] - m);
    float sum = e0 + e1;
#pragma unroll
    for (int off = 32; off > 0; off >>= 1) sum += __shfl_xor(sum, off);
    sum += expf(sink - m);
    pr[lane] = e0 / sum; pr[lane + 64] = e1 / sum;
    __syncthreads();
    float acc = 0.f;
    for (int dist = 0; dist < 128; ++dist) { const int s = t - dist; if (s < 0) break; acc = fmaf(pr[dist], kv[(size_t)s * 512 + 256 + kvh * 64 + lane], acc); }
    o[(size_t)t * 1024 + hq * 64 + lane] = acc;
}

inline void gemm(hipStream_t st, const float* A, int lda, const float* W, int ldw, const float* bias, float* C, int ldc, int M, int N, int K) {
    hipLaunchKernelGGL(k_gemm, dim3(N / 64, M / 64), dim3(256), 0, st, A, lda, W, ldw, bias, C, ldc, K);
}
}

extern "C" void kernel_launch(void* const* d_in, const int* in_sizes, int n_in, void* d_out, int out_size, void* d_ws, size_t ws_size, hipStream_t stream) {
    using namespace nv;
    const float* x = (const float*)d_in[0]; const float* p = (const float*)d_in[1];
    const float* a_w_in = (const float*)d_in[2]; const float* a_lb = (const float*)d_in[3]; const float* a_gain = (const float*)d_in[4]; const float* a_w_out = (const float*)d_in[5];
    const float* kv_w = (const float*)d_in[6]; const float* kv_b = (const float*)d_in[7]; const float* b_w_q = (const float*)d_in[8]; const float* b_b_q = (const float*)d_in[9];
    const float* b_sinks = (const float*)d_in[10]; const float* b_w_out = (const float*)d_in[11]; const float* b_b_out = (const float*)d_in[12];
    const float* ffn_gu = (const float*)d_in[13]; const float* ffn_down = (const float*)d_in[14]; const float* ple_up = (const float*)d_in[15]; const float* ple_gate = (const float*)d_in[16];
    const float* ple_bg = (const float*)d_in[17]; const float* ln_g = (const float*)d_in[18]; const float* ln_b = (const float*)d_in[19];
    float* out = (float*)d_out;
    float* ws = (float*)d_ws;
    float* lb = ws;
    float* big = ws + 4096;
    float* t1 = big + (size_t)S * 5632;
    float* t2 = t1 + (size_t)S * 2816;
    float* t3 = t2 + (size_t)S * 1024;
    float* xa = t3 + (size_t)S * 1024;
    float* xb = xa + (size_t)S * 1024;
    hipLaunchKernelGGL(k_lb, dim3(4), dim3(256), 0, stream, a_lb, lb);
    for (int b = 0; b < B; ++b) {
        const float* xin = x + (size_t)b * S * D;
        float* xo = out + (size_t)b * S * D;
        gemm(stream, xin, D, a_w_in, 4096, nullptr, big, 4096, S, 4096, D);
        hipLaunchKernelGGL(k_hgrn, dim3(8), dim3(128), 0, stream, big, lb, t2);
        hipLaunchKernelGGL(k_gatenorm, dim3(S, 8), dim3(128), 0, stream, t2, big, a_gain, t3);
        gemm(stream, t3, D, a_w_out, D, nullptr, t2, D, S, D, D);
        hipLaunchKernelGGL(k_addln, dim3(S), dim3(256), 0, stream, xin, t2, ln_g + 0 * D, ln_b + 0 * D, xa);
        gemm(stream, xa, D, ffn_gu, 2 * FF, nullptr, big, 2 * FF, S, 2 * FF, D);
        hipLaunchKernelGGL(k_swiglu, dim3((S * FF + 255) / 256), dim3(256), 0, stream, big, t1, S * FF);
        gemm(stream, t1, FF, ffn_down, D, nullptr, t2, D, S, D, FF);
        hipLaunchKernelGGL(k_addln, dim3(S), dim3(256), 0, stream, xa, t2, ln_g + 1 * D, ln_b + 1 * D, xb);
        gemm(stream, xb, D, ple_gate, D, ple_bg, t2, D, S, D, D);
        gemm(stream, p + (size_t)b * S * PLE, PLE, ple_up, D, nullptr, t3, D, S, D, PLE);
        hipLaunchKernelGGL(k_sigmul, dim3((S * D + 255) / 256), dim3(256), 0, stream, t2, t3, t2, S * D);
        hipLaunchKernelGGL(k_addln, dim3(S), dim3(256), 0, stream, xb, t2, ln_g + 2 * D, ln_b + 2 * D, xa);
        gemm(stream, xa, D, kv_w, 512, kv_b, t1, 512, S, 512, D);
        gemm(stream, xa, D, b_w_q, D, b_b_q, t2, D, S, D, D);
        hipLaunchKernelGGL(k_swa, dim3(S, 16), dim3(64), 0, stream, t2, t1, b_sinks, t3);
        gemm(stream, t3, D, b_w_out, D, b_b_out, t2, D, S, D, D);
        hipLaunchKernelGGL(k_addln, dim3(S), dim3(256), 0, stream, xa, t2, ln_g + 3 * D, ln_b + 3 * D, xb);
        gemm(stream, xb, D, ffn_gu + (size_t)D * 2 * FF, 2 * FF, nullptr, big, 2 * FF, S, 2 * FF, D);
        hipLaunchKernelGGL(k_swiglu, dim3((S * FF + 255) / 256), dim3(256), 0, stream, big, t1, S * FF);
        gemm(stream, t1, FF, ffn_down + (size_t)FF * D, D, nullptr, t2, D, S, D, FF);
        hipLaunchKernelGGL(k_addln, dim3(S), dim3(256), 0, stream, xb, t2, ln_g + 4 * D, ln_b + 4 * D, xa);
        gemm(stream, xa, D, ple_gate + (size_t)D * D, D, ple_bg + D, t2, D, S, D, D);
        gemm(stream, p + (size_t)(B + b) * S * PLE, PLE, ple_up + (size_t)PLE * D, D, nullptr, t3, D, S, D, PLE);
        hipLaunchKernelGGL(k_sigmul, dim3((S * D + 255) / 256), dim3(256), 0, stream, t2, t3, t2, S * D);
        hipLaunchKernelGGL(k_addln, dim3(S), dim3(256), 0, stream, xa, t2, ln_g + 5 * D, ln_b + 5 * D, xo);
    }
}
```
